# Optimizing an MI355X kernel written in HIP

```python
import jax, jax.numpy as jnp
from jax import lax
import numpy as np

D_MODEL = 1024
BATCH = 4
SEQ = 4096
DEPTH = 1

N_MEM = 256
CONV_WIDTH = 512
CONV_KERNEL = 31
MLA_HEADS = 8
QK_NOPE = 64
QK_ROPE = 32
V_HEAD = 64
Q_LORA = 384
KV_LORA = 256
MLA_WIDTH = MLA_HEADS * V_HEAD
X_HEADS = 4
X_HEAD_DIM = 128
X_WIDTH = X_HEADS * X_HEAD_DIM
N_BRANCH = 3
ROPE_THETA = 10000.0
BLOCK_Q = 128
EPS = 1e-6
IN_SPLITS = (CONV_WIDTH, CONV_WIDTH, CONV_WIDTH, Q_LORA, KV_LORA, QK_ROPE, MLA_WIDTH, X_WIDTH, X_WIDTH, N_BRANCH * D_MODEL)
D_IN = sum(IN_SPLITS)

kernel_name = 'hybrid_conv_mla_xattn_gated_block'


def rms_norm(x, g):
    xf = x.astype(jnp.float32)
    y = xf * lax.rsqrt(jnp.mean(xf * xf, axis=-1, keepdims=True) + EPS)
    return (y * g.astype(jnp.float32)).astype(x.dtype)


def layer_norm(x, g, b):
    xf = x.astype(jnp.float32)
    mu = jnp.mean(xf, axis=-1, keepdims=True)
    var = jnp.mean(jnp.square(xf - mu), axis=-1, keepdims=True)
    y = (xf - mu) * lax.rsqrt(var + EPS)
    return (y * g.astype(jnp.float32) + b.astype(jnp.float32)).astype(x.dtype)


def apply_rope(x, cos, sin):
    xf = x.astype(jnp.float32)
    x1, x2 = jnp.split(xf, 2, axis=-1)
    out = jnp.concatenate([x1 * cos - x2 * sin, x1 * sin + x2 * cos], axis=-1)
    return out.astype(x.dtype)


def conv_branch(val, glu, gate, conv_w, conv_b, ln_g, ln_b, w_o):
    u = val * jax.nn.sigmoid(glu)
    u = lax.conv_general_dilated(
        u, conv_w[:, None, :], window_strides=(1,),
        padding=[(CONV_KERNEL - 1, 0)],
        dimension_numbers=('NWC', 'WIO', 'NWC'),
        feature_group_count=CONV_WIDTH) + conv_b
    u = jax.nn.silu(layer_norm(u, ln_g, ln_b))
    u = u * jax.nn.silu(gate)
    return u @ w_o


def mla_branch(q_down, kv_down, k_rope_raw, gate, cos, sin,
               q_norm_g, w_uq, kv_norm_g, w_ukv, w_o):
    B, S, _ = q_down.shape
    cq = rms_norm(q_down, q_norm_g)
    q = (cq @ w_uq).reshape(B, S, MLA_HEADS, QK_NOPE + QK_ROPE)
    q_nope = q[..., :QK_NOPE]
    q_rope = apply_rope(q[..., QK_NOPE:], cos[:, :, None, :], sin[:, :, None, :])
    ckv = rms_norm(kv_down, kv_norm_g)
    kv = (ckv @ w_ukv).reshape(B, S, MLA_HEADS, QK_NOPE + V_HEAD)
    k_nope = kv[..., :QK_NOPE]
    v = kv[..., QK_NOPE:]
    k_rope = apply_rope(k_rope_raw, cos, sin)
    scale = (QK_NOPE + QK_ROPE) ** -0.5
    n_blk = S // BLOCK_Q
    qn_b = (q_nope * scale).reshape(B, n_blk, BLOCK_Q, MLA_HEADS, QK_NOPE).transpose(1, 0, 2, 3, 4)
    qr_b = (q_rope * scale).reshape(B, n_blk, BLOCK_Q, MLA_HEADS, QK_ROPE).transpose(1, 0, 2, 3, 4)
    k_pos = jnp.arange(S)
    neg = jnp.finfo(jnp.float32).min

    def attend(args):
        qn, qr, blk = args
        s = (jnp.einsum('bqhd,bkhd->bhqk', qn, k_nope)
             + jnp.einsum('bqhr,bkr->bhqk', qr, k_rope)).astype(jnp.float32)
        q_pos = blk * BLOCK_Q + jnp.arange(BLOCK_Q)
        causal = k_pos[None, :] <= q_pos[:, None]
        p = jax.nn.softmax(jnp.where(causal, s, neg), axis=-1).astype(v.dtype)
        return jnp.einsum('bhqk,bkhd->bqhd', p, v)

    o = lax.map(attend, (qn_b, qr_b, jnp.arange(n_blk)))
    o = o.transpose(1, 0, 2, 3, 4).reshape(B, S, MLA_WIDTH)
    return (o * jax.nn.silu(gate)) @ w_o


def cross_branch(xq, gate, mem, mem_norm_g, w_mem_kv, w_o):
    B, S, _ = xq.shape
    M = mem.shape[1]
    q = xq.reshape(B, S, X_HEADS, X_HEAD_DIM)
    mkv = rms_norm(mem, mem_norm_g) @ w_mem_kv
    k = mkv[..., :X_WIDTH].reshape(B, M, X_HEADS, X_HEAD_DIM)
    v = mkv[..., X_WIDTH:].reshape(B, M, X_HEADS, X_HEAD_DIM)
    s = jnp.einsum('bshd,bmhd->bhsm', q, k).astype(jnp.float32) * (X_HEAD_DIM ** -0.5)
    p = jax.nn.softmax(s, axis=-1).astype(v.dtype)
    o = jnp.einsum('bhsm,bmhd->bshd', p, v).reshape(B, S, X_WIDTH)
    return (o * jax.nn.silu(gate)) @ w_o


def setup_inputs(seed: int = 0) -> dict:
    key = jax.random.key(seed)
    ks = jax.random.split(key, 24)
    f32 = jnp.float32

    def nrm(k, shape, fan_in):
        return jax.random.normal(k, shape, f32) * (fan_in ** -0.5)

    def gain(k, shape):
        return 1.0 + 0.02 * jax.random.normal(k, shape, f32)

    x = jax.random.normal(ks[0], (BATCH, SEQ, D_MODEL), f32)
    mem = jax.random.normal(ks[1], (BATCH, N_MEM, D_MODEL), f32)
    offset = jax.random.randint(ks[2], (BATCH, 1), 0, 1024, dtype=jnp.int32)
    positions = (offset + jnp.arange(SEQ, dtype=jnp.int32)[None, :]).astype(jnp.int32)
    return {
        'x': x,
        'mem': mem,
        'positions': positions,
        'norm_g': gain(ks[3], (DEPTH, D_MODEL)),
        'w_in': nrm(ks[4], (DEPTH, D_MODEL, D_IN), D_MODEL),
        'b_gate': 0.01 * jax.random.normal(ks[5], (DEPTH, N_BRANCH * D_MODEL), f32),
        'conv_w': nrm(ks[6], (DEPTH, CONV_KERNEL, CONV_WIDTH), CONV_KERNEL),
        'conv_b': 0.01 * jax.random.normal(ks[7], (DEPTH, CONV_WIDTH), f32),
        'conv_ln_g': gain(ks[8], (DEPTH, CONV_WIDTH)),
        'conv_ln_b': 0.01 * jax.random.normal(ks[9], (DEPTH, CONV_WIDTH), f32),
        'w_conv_o': nrm(ks[10], (DEPTH, CONV_WIDTH, D_MODEL), CONV_WIDTH),
        'q_norm_g': gain(ks[11], (DEPTH, Q_LORA)),
        'w_uq': nrm(ks[12], (DEPTH, Q_LORA, MLA_HEADS * (QK_NOPE + QK_ROPE)), Q_LORA),
        'kv_norm_g': gain(ks[13], (DEPTH, KV_LORA)),
        'w_ukv': nrm(ks[14], (DEPTH, KV_LORA, MLA_HEADS * (QK_NOPE + V_HEAD)), KV_LORA),
        'w_mla_o': nrm(ks[15], (DEPTH, MLA_WIDTH, D_MODEL), MLA_WIDTH),
        'mem_norm_g': gain(ks[16], (DEPTH, D_MODEL)),
        'w_mem_kv': nrm(ks[17], (DEPTH, D_MODEL, 2 * X_WIDTH), D_MODEL),
        'w_x_o': nrm(ks[18], (DEPTH, X_WIDTH, D_MODEL), X_WIDTH),
        'w_out': nrm(ks[19], (DEPTH, D_MODEL, D_MODEL), D_MODEL),
        'final_norm_g': gain(ks[20], (D_MODEL,)),
    }


def reference(x, mem, positions, norm_g, w_in, b_gate, conv_w, conv_b, conv_ln_g,
              conv_ln_b, w_conv_o, q_norm_g, w_uq, kv_norm_g, w_ukv, w_mla_o,
              mem_norm_g, w_mem_kv, w_x_o, w_out, final_norm_g):
    B, S, D = x.shape
    split_idx = np.cumsum(np.array(IN_SPLITS))[:-1].tolist()
    inv_freq = ROPE_THETA ** (-jnp.arange(0, QK_ROPE, 2, dtype=jnp.float32) / QK_ROPE)
    angles = positions.astype(jnp.float32)[..., None] * inv_freq
    cos, sin = jnp.cos(angles), jnp.sin(angles)
    for l in range(DEPTH):
        h = rms_norm(x, norm_g[l])
        z = h @ w_in[l]
        (c_val, c_glu, c_gate, q_down, kv_down, k_rope_raw, m_gate,
         x_q, x_gate, g_logits) = jnp.split(z, split_idx, axis=-1)
        y_conv = conv_branch(c_val, c_glu, c_gate, conv_w[l], conv_b[l],
                             conv_ln_g[l], conv_ln_b[l], w_conv_o[l])
        y_mla = mla_branch(q_down, kv_down, k_rope_raw, m_gate, cos, sin,
                           q_norm_g[l], w_uq[l], kv_norm_g[l], w_ukv[l], w_mla_o[l])
        y_x = cross_branch(x_q, x_gate, mem, mem_norm_g[l], w_mem_kv[l], w_x_o[l])
        g = jax.nn.sigmoid((g_logits + b_gate[l]).reshape(B, S, N_BRANCH, D))
        merged = g[:, :, 0] * y_conv + g[:, :, 1] * y_mla + g[:, :, 2] * y_x
        x = x + merged @ w_out[l]
    return rms_norm(x, final_norm_g)
```

```cpp
#include <hip/hip_runtime.h>
#include <hip/hip_bf16.h>
#include <cstdio>
#include <cstdint>

#ifndef MK_N_LAUNCHES
#define MK_N_LAUNCHES 7
#endif

constexpr int DM = 1024, NB = 4, SEQ = 4096, T = NB * SEQ, NMEM = 256;
constexpr int CW = 512, CKER = 31, NH = 8, NOPE = 64, ROPE = 32, VH = 64, QL = 384, KVL = 256, MW = 512, XH = 4, XHD = 128, XW = 512;
constexpr int DIN = 6816, NSLOT = 6912;
constexpr int QW = NH * (NOPE + ROPE);
constexpr int KVW = NH * (NOPE + VH);
constexpr float EPS = 1e-6f;
constexpr float LOG2E = 1.4426950408889634f;
constexpr float QSCALE = 0.10206207261596577f * LOG2E;
constexpr float XSCALE = 0.08838834764831845f * LOG2E;
constexpr int SRC_VAL = 0, SRC_GLU = 512, SRC_CG = 1024, SRC_QD = 1536, SRC_KVD = 1920, SRC_KR = 2176, SRC_MG = 2208, SRC_XQ = 2720, SRC_XG = 3232, SRC_G = 3744;
constexpr int SL_U = 0, SL_CG = 1024, SL_QD = 1536, SL_KVD = 1920, SL_MG = 2176, SL_XQ = 2688, SL_XG = 3200, SL_G = 3712, SL_KR = 6784;
constexpr int NPSQ = 20;

typedef unsigned short bf16_t;
typedef short bf16x8 __attribute__((ext_vector_type(8)));
typedef short s16x4 __attribute__((ext_vector_type(4)));
typedef float f32x2 __attribute__((ext_vector_type(2)));
typedef float f32x4 __attribute__((ext_vector_type(4)));
typedef float f32x16 __attribute__((ext_vector_type(16)));
typedef unsigned u32x2 __attribute__((ext_vector_type(2)));
typedef unsigned u32x4 __attribute__((ext_vector_type(4)));
#define LAS __attribute__((address_space(3)))
#define GAS __attribute__((address_space(1)))

constexpr size_t MiB = 1u << 20;
constexpr size_t WS_CTL = 0;
constexpr size_t CTL_BYTES = 64 * 1024;
constexpr size_t WS_PSQ = MiB / 4;
constexpr size_t WS_WSM = 3 * MiB / 2;
constexpr size_t WS_WUQ = WS_WSM;
constexpr size_t WS_WUKV = WS_WUQ + (size_t)QW * QL * 2;
constexpr size_t WS_WCO = WS_WUKV + (size_t)KVW * KVL * 2;
constexpr size_t WS_WMO = WS_WCO + (size_t)DM * CW * 2;
constexpr size_t WS_WXO = WS_WMO + (size_t)DM * MW * 2;
constexpr size_t WS_WOUT = WS_WXO + (size_t)DM * XW * 2;
constexpr size_t WS_R0 = 31 * MiB / 4;
constexpr size_t WS_H = WS_R0;
constexpr size_t WS_MEMN = WS_H + (size_t)T * DM * 2;
constexpr size_t WS_WIN = WS_MEMN + (size_t)NB * NMEM * DM * 2;
constexpr size_t WS_WMKV = WS_WIN + (size_t)NSLOT * DM * 2;
constexpr size_t WS_MERGED = WS_H;
constexpr size_t WS_Z = WS_WMKV + 2 * MiB;
constexpr size_t WS_UPRE = WS_Z;
constexpr size_t WS_CG = WS_UPRE + 16 * MiB;
constexpr size_t WS_QD = WS_CG + 16 * MiB;
constexpr size_t WS_KVD = WS_QD + 12 * MiB;
constexpr size_t WS_MG = WS_KVD + 8 * MiB;
constexpr size_t WS_XQ = WS_MG + 16 * MiB;
constexpr size_t WS_XG = WS_XQ + 16 * MiB;
constexpr size_t WS_G = WS_XG + 16 * MiB;
constexpr size_t WS_END = WS_G + 96 * MiB;
static_assert(WS_PSQ >= CTL_BYTES && WS_PSQ + (size_t)T * NPSQ * 4 <= WS_WSM && WS_WOUT + (size_t)DM * DM * 2 <= WS_R0 && WS_WMKV + 2 * MiB <= WS_Z && WS_END <= 256 * MiB && WS_Z % 256 == 0, "d_ws map");
constexpr size_t WO_KV = 0;
constexpr size_t WO_Q = 32 * MiB;
constexpr size_t WO_MEMKV = 56 * MiB;
constexpr size_t WO_CS = 60 * MiB;
constexpr size_t WO_KR = 62 * MiB;

typedef __bf16 bf16x2_t __attribute__((ext_vector_type(2)));
__device__ __forceinline__ unsigned cvt_pk_bf16(float lo, float hi) { f32x2 v = {lo, hi}; bf16x2_t b = __builtin_convertvector(v, bf16x2_t); return __builtin_bit_cast(unsigned, b); }
__device__ __forceinline__ float bf_lo(unsigned u) { return __uint_as_float(u << 16); }
__device__ __forceinline__ float bf_hi(unsigned u) { return __uint_as_float(u & 0xffff0000u); }
__device__ __forceinline__ float sigmoidf_(float v) { return __builtin_amdgcn_rcpf(1.f + __builtin_amdgcn_exp2f(-LOG2E * v)); }
__device__ __forceinline__ float siluf_(float v) { return v * sigmoidf_(v); }
__device__ __forceinline__ float wave_sum(float v) {
#pragma unroll
    for (int o = 1; o < 64; o <<= 1) v += __shfl_xor(v, o);
    return v;
}
__device__ __forceinline__ int opaque_tid() { int t = threadIdx.x; asm volatile("" : "+v"(t)); return t; }
#define LDS_WAIT() asm volatile("s_waitcnt lgkmcnt(0)" ::: "memory")
#define VM_WAIT() asm volatile("s_waitcnt vmcnt(0)" ::: "memory")

namespace pg8 {
constexpr int BM = 256, BK = 64, HALF = 128, HTB = HALF * BK * 2, STAGE_BYTES = 8 * HTB, NXCD = 8, WGM = 8;
__host__ __device__ __forceinline__ int lds_byte(int r, int c) { const int st = (r >> 4) * 2 + (c >> 5), rr = r & 15, cc = c & 31, ob = rr * 64 + cc * 2; return st * 1024 + (ob ^ (((ob >> 9) & 1) << 5)); }
__host__ __device__ __forceinline__ void stage_rc(int b, int& R, int& C) { const int st = b / 1024, sb = b % 1024, swz = sb ^ (((sb >> 9) & 1) << 5); R = (st >> 1) * 16 + swz / 64; C = (st & 1) * 32 + (swz % 64) / 2; }
__host__ __device__ __forceinline__ int perm32(int rho) { const int n = rho >> 4, i = rho & 15; return 8 * (i >> 2) + 4 * n + (i & 3); }

struct Unit { int pm, pn, sub; };
struct Gemm {
    const bf16_t* A0; const bf16_t* A1; const bf16_t* A2; const bf16_t* B0; const bf16_t* B1; const bf16_t* B2; int lda, ldb, K;
    static __device__ __forceinline__ const bf16_t* sel3(int s, const bf16_t* a, const bf16_t* b, const bf16_t* c) { const bf16_t* p = a; if (s == 1) p = b; if (s == 2) p = c; return p; }
    __device__ __forceinline__ const char* a_tile(const Unit& u) const { return (const char*)sel3(u.sub, A0, A1, A2) + (size_t)u.pm * BM * lda * 2; }
    __device__ __forceinline__ const char* b_tile(const Unit& u) const { return (const char*)sel3(u.sub, B0, B1, B2) + (size_t)u.pn * BM * ldb * 2; }
};
struct StaticOrder {
    int nM, nN, nwg, G, c;
    __device__ void init(int M, int N, int G_, int c_) { nM = M / BM; nN = N / BM; nwg = nM * nN; G = G_; c = c_; }
    __device__ bool next(int i, Unit& u) const {
        const long L = (long)i * G + c; if (L >= nwg) return false;
        int wgid = (int)L; { const int q = nwg / NXCD, r = nwg % NXCD, xcd = wgid % NXCD, off = wgid / NXCD; wgid = (xcd < r ? xcd * (q + 1) : r * (q + 1) + (xcd - r) * q) + off; }
        const int nig = WGM * nN, gid = wgid / nig, fm = gid * WGM, gsz = (nM - fm) < WGM ? (nM - fm) : WGM;
        u.pm = fm + ((wgid % nig) % gsz); u.pn = (wgid % nig) / gsz; u.sub = 0; return true;
    }
};
struct OrderG1 {
    StaticOrder so;
    __device__ void init(int G_, int c_) { so.init(T, NSLOT, G_, c_); }
    __device__ bool next(int i, Unit& u) const {
        if (so.next(i, u)) return true;
        const int nstd = (so.nwg - so.c + so.G - 1) / so.G;
        const int first_short = so.nwg % so.G;
        const int e = so.c - first_short;
        if (i == nstd && e >= 0 && e < 16) { u.pm = 64 + (e >> 2); u.pn = 27 + (e & 3); u.sub = 0; return true; }
        return false;
    }
};
struct OrderSub3 {
    StaticOrder so;
    __device__ void init(int M, int N, int G_, int c_) { so.init(M, N, G_, c_); }
    __device__ bool next(int i, Unit& u) const { if (!so.next(i / 3, u)) return false; u.sub = i % 3; return true; }
};

template <class Epi, class Sched, bool ALIGN_EPI>
__device__ __forceinline__ void gemm_phase(LAS unsigned char* lds, const Gemm g, const Sched& S, const Epi& E) {
    const int tid = opaque_tid(), wid = __builtin_amdgcn_readfirstlane(tid >> 6), lane = tid & 63, wr = wid >> 2, wc = wid & 3, fr = lane & 15, fq = lane >> 4;
    const int K = g.K, nt = K / BK;
    unsigned voffA[2], voffB[2];
#pragma unroll
    for (int i = 0; i < 2; ++i) { int R, C; stage_rc(tid * 16 + i * 8192, R, C); voffA[i] = (unsigned)(R * g.lda + C) * 2u; voffB[i] = (unsigned)(R * g.ldb + C) * 2u; }
    const size_t kstep = (size_t)(BK * 2);
    const size_t hstepA = (size_t)HALF * g.lda * 2, hstepB = (size_t)HALF * g.ldb * 2;
    const unsigned ldsw = (unsigned)wid * 1024u;
    const int aoff = lds_byte(wr * 64 + fr, fq * 8), boff = lds_byte(wc * 32 + fr, fq * 8);
#define PG8_SA(b, h) (((b) * 2 + (h)) * HTB)
#define PG8_SB(b, h) ((4 + (b) * 2 + (h)) * HTB)
#define PG8_STAGE(bufoff, gbase, voff) do { _Pragma("unroll") for (int _i = 0; _i < 2; ++_i) \
        __builtin_amdgcn_global_load_lds((const unsigned*)((const char*)(gbase) + (voff)[_i]), (LAS unsigned*)(lds + (bufoff) + ldsw + _i * 8192), 16, 0, 0); } while (0)
#define PG8_LDA(dst, b, h) do { _Pragma("unroll") for (int m = 0; m < 4; ++m) _Pragma("unroll") for (int k = 0; k < 2; ++k) dst[m][k] = *(const LAS bf16x8*)(lds + PG8_SA(b, h) + aoff + m * 2048 + k * 1024); } while (0)
#define PG8_LDB(dst, b, h) do { _Pragma("unroll") for (int n = 0; n < 2; ++n) _Pragma("unroll") for (int k = 0; k < 2; ++k) dst[n][k] = *(const LAS bf16x8*)(lds + PG8_SB(b, h) + boff + n * 2048 + k * 1024); } while (0)
#define PG8_MMA(ai, bj, At, Bt) do { __builtin_amdgcn_s_setprio(1); _Pragma("unroll") for (int m = 0; m < 4; ++m) _Pragma("unroll") for (int n = 0; n < 2; ++n) _Pragma("unroll") for (int k = 0; k < 2; ++k) \
        acc[ai][bj][m][n] = __builtin_amdgcn_mfma_f32_16x16x32_bf16(Bt[n][k], At[m][k], acc[ai][bj][m][n], 0, 0, 0); __builtin_amdgcn_s_setprio(0); } while (0)
#define PG8_WAIT_V(n) asm volatile("s_waitcnt vmcnt(" #n ")" ::: "memory")
#define PG8_WAIT_L(n) asm volatile("s_waitcnt lgkmcnt(" #n ")" ::: "memory")
#define PG8_BAR __builtin_amdgcn_s_barrier()
#define PG8_SCHED __builtin_amdgcn_sched_barrier(0)
    Unit cur, nxt; int ui = 0;
    if (!S.next(0, cur)) return;
    f32x4 acc[2][2][4][2];
#pragma unroll
    for (int a = 0; a < 2; ++a)
#pragma unroll
        for (int b = 0; b < 2; ++b)
#pragma unroll
            for (int m = 0; m < 4; ++m)
#pragma unroll
                for (int n = 0; n < 2; ++n) acc[a][b][m][n] = (f32x4){0.f, 0.f, 0.f, 0.f};
    bf16x8 At[4][2], B0[2][2], B1[2][2];
    const char* cA = g.a_tile(cur); const char* cB = g.b_tile(cur);
    PG8_STAGE(PG8_SB(0, 0), cB, voffB); PG8_STAGE(PG8_SB(0, 1), cB + hstepB, voffB); PG8_STAGE(PG8_SA(0, 0), cA, voffA); PG8_STAGE(PG8_SA(0, 1), cA + hstepA, voffA);
    if (wr == 1) PG8_BAR;
    PG8_WAIT_V(2); PG8_BAR;
    PG8_STAGE(PG8_SB(1, 0), cB + kstep, voffB); PG8_STAGE(PG8_SA(1, 0), cA + kstep, voffA); PG8_STAGE(PG8_SB(1, 1), cB + hstepB + kstep, voffB);
    PG8_WAIT_V(6); PG8_BAR;
    for (;;) {
        const bool has_next = S.next(ui + 1, nxt);
        const char* nA = has_next ? g.a_tile(nxt) : cA; const char* nB = has_next ? g.b_tile(nxt) : cB;
        for (int t = 0; t < nt; t += 2) {
            const bool last = (t == nt - 2);
            const char* a1 = cA + (size_t)(t + 1) * kstep;
            const char* a2 = last ? nA : cA + (size_t)(t + 2) * kstep; const char* b2 = last ? nB : cB + (size_t)(t + 2) * kstep;
            const char* a3 = a2 + kstep; const char* b3 = b2 + kstep;
            PG8_LDB(B0, 0, 0); PG8_LDB(B1, 0, 1); PG8_SCHED; PG8_LDA(At, 0, 0); PG8_STAGE(PG8_SA(1, 1), a1 + hstepA, voffA);
            PG8_WAIT_V(8); PG8_WAIT_L(0); PG8_BAR; PG8_MMA(0, 0, At, B0); PG8_MMA(0, 1, At, B1); PG8_BAR; PG8_SCHED;
            PG8_LDA(At, 0, 1); PG8_STAGE(PG8_SB(0, 0), b2, voffB); PG8_STAGE(PG8_SB(0, 1), b2 + hstepB, voffB); PG8_STAGE(PG8_SA(0, 0), a2, voffA);
            PG8_WAIT_V(8); PG8_WAIT_L(0); PG8_BAR; PG8_MMA(1, 0, At, B0); PG8_MMA(1, 1, At, B1); PG8_BAR; PG8_SCHED;
            PG8_LDB(B0, 1, 0); PG8_LDB(B1, 1, 1); PG8_SCHED; PG8_LDA(At, 1, 0); PG8_STAGE(PG8_SA(0, 1), a2 + hstepA, voffA);
            PG8_WAIT_V(8); PG8_WAIT_L(0); PG8_BAR; PG8_MMA(0, 0, At, B0); PG8_MMA(0, 1, At, B1); PG8_BAR; PG8_SCHED;
            PG8_LDA(At, 1, 1); PG8_STAGE(PG8_SB(1, 0), b3, voffB); PG8_STAGE(PG8_SB(1, 1), b3 + hstepB, voffB); PG8_STAGE(PG8_SA(1, 0), a3, voffA);
            PG8_WAIT_V(8); PG8_WAIT_L(0); PG8_BAR; PG8_MMA(1, 0, At, B0); PG8_MMA(1, 1, At, B1); PG8_BAR; PG8_SCHED;
        }
        if constexpr (ALIGN_EPI) { if (wr == 0) PG8_BAR; }
        E(acc, cur);
        if (!has_next) break;
        if (E.zero_after(cur)) {
#pragma unroll
            for (int a = 0; a < 2; ++a)
#pragma unroll
                for (int b = 0; b < 2; ++b)
#pragma unroll
                    for (int m = 0; m < 4; ++m)
#pragma unroll
                        for (int n = 0; n < 2; ++n) acc[a][b][m][n] = (f32x4){0.f, 0.f, 0.f, 0.f};
        }
        cur = nxt; cA = nA; cB = nB; ++ui;
        if constexpr (ALIGN_EPI) { if (wr == 1) PG8_BAR; }
    }
    PG8_WAIT_V(0);
    if constexpr (!ALIGN_EPI) { if (wr == 0) PG8_BAR; }
    PG8_BAR;
#undef PG8_SA
#undef PG8_SB
#undef PG8_STAGE
#undef PG8_LDA
#undef PG8_LDB
#undef PG8_MMA
#undef PG8_WAIT_V
#undef PG8_WAIT_L
#undef PG8_BAR
#undef PG8_SCHED
}

typedef f32x4 Acc[2][2][4][2];
__device__ __forceinline__ u32x4 pack8(f32x4 a, f32x4 b) { u32x4 w; w.x = cvt_pk_bf16(a[0], a[1]); w.y = cvt_pk_bf16(a[2], a[3]); w.z = cvt_pk_bf16(b[0], b[1]); w.w = cvt_pk_bf16(b[2], b[3]); return w; }
template <int ACT> __device__ __forceinline__ void store_half(const Acc& acc, int bj, bf16_t* dst, int ld, int row0, int col0, float scale, const float* bias) {
    f32x4 b0 = (f32x4){0.f, 0.f, 0.f, 0.f}, b1 = b0;
    if (ACT == 2) { b0 = *(const f32x4*)(bias + col0); b1 = *(const f32x4*)(bias + col0 + 4); }
#pragma unroll
    for (int ai = 0; ai < 2; ++ai)
#pragma unroll
        for (int m = 0; m < 4; ++m) {
            f32x4 v0 = acc[ai][bj][m][0], v1 = acc[ai][bj][m][1];
            if (ACT == 0) { v0 = v0 * scale; v1 = v1 * scale; }
            if (ACT == 1) {
#pragma unroll
                for (int j = 0; j < 4; ++j) { v0[j] = siluf_(v0[j]); v1[j] = siluf_(v1[j]); } }
            if (ACT == 2) { v0 = v0 + b0; v1 = v1 + b1;
#pragma unroll
                for (int j = 0; j < 4; ++j) { v0[j] = sigmoidf_(v0[j]); v1[j] = sigmoidf_(v1[j]); } }
            *(u32x4*)(dst + (unsigned)((row0 + ai * HALF + m * 16) * ld + col0)) = pack8(v0, v1);
            asm volatile("" ::: "memory");
        }
}
__device__ __forceinline__ void psq_half(const Acc& acc, int bj, float* psq, int row0, int gi, int fq) {
#pragma unroll
    for (int ai = 0; ai < 2; ++ai)
#pragma unroll
        for (int m = 0; m < 4; ++m) {
            const f32x4 v0 = acc[ai][bj][m][0], v1 = acc[ai][bj][m][1];
            float s = (v0[0] * v0[0] + v0[1] * v0[1]) + (v0[2] * v0[2] + v0[3] * v0[3]) + (v1[0] * v1[0] + v1[1] * v1[1]) + (v1[2] * v1[2] + v1[3] * v1[3]);
            s += __shfl_xor(s, 16); s += __shfl_xor(s, 32);
            if (fq == 0) psq[(unsigned)((row0 + ai * HALF + m * 16) * NPSQ + gi)] = s;
        }
}

struct EpiG1 {
    bf16_t *UPRE, *CG, *QD, *KVD, *MG, *XQ, *XG, *G, *KR, *MEMKV; float* PSQ; const float* bgate; const float* CS;
    __device__ __forceinline__ bool zero_after(const Unit&) const { return true; }
    __device__ __forceinline__ void operator()(Acc& acc, const Unit& u) const {
        const int tid_ = opaque_tid(), wid_ = __builtin_amdgcn_readfirstlane(tid_ >> 6), wr = wid_ >> 2, wc = wid_ & 3, fr = tid_ & 15, fq = (tid_ & 63) >> 4;
        const int row0 = u.pm * BM + wr * 64 + fr;
        if (u.pm >= 64) {
            const int r0 = row0 - T;
#pragma unroll
            for (int bj = 0; bj < 2; ++bj) store_half<0>(acc, bj, MEMKV, 2 * XW, r0, (u.pn - 27) * BM + bj * HALF + wc * 32 + fq * 8, 1.f, nullptr);
            return;
        }
        if (u.pn < 4) {
            const int col0 = u.pn * HALF + wc * 32 + fq * 8;
#pragma unroll
            for (int ai = 0; ai < 2; ++ai)
#pragma unroll
                for (int m = 0; m < 4; ++m) {
                    f32x4 v0 = acc[ai][0][m][0], v1 = acc[ai][0][m][1]; const f32x4 g0 = acc[ai][1][m][0], g1 = acc[ai][1][m][1];
#pragma unroll
                    for (int j = 0; j < 4; ++j) { v0[j] *= sigmoidf_(g0[j]); v1[j] *= sigmoidf_(g1[j]); }
                    *(u32x4*)(UPRE + (unsigned)((row0 + ai * HALF + m * 16) * CW + col0)) = pack8(v0, v1);
                }
            return;
        }
#pragma unroll
        for (int bj = 0; bj < 2; ++bj) {
            const int ht = 2 * u.pn + bj, lc = wc * 32 + fq * 8;
            if (ht < 12) store_half<1>(acc, bj, CG, CW, row0, (ht - 8) * HALF + lc, 1.f, nullptr);
            else if (ht < 15) { store_half<0>(acc, bj, QD, QL, row0, (ht - 12) * HALF + lc, 1.f, nullptr); psq_half(acc, bj, PSQ, row0, (ht - 12) * 4 + wc, fq); }
            else if (ht < 17) { store_half<0>(acc, bj, KVD, KVL, row0, (ht - 15) * HALF + lc, 1.f, nullptr); psq_half(acc, bj, PSQ, row0, 12 + (ht - 15) * 4 + wc, fq); }
            else if (ht < 21) store_half<1>(acc, bj, MG, MW, row0, (ht - 17) * HALF + lc, 1.f, nullptr);
            else if (ht < 25) store_half<0>(acc, bj, XQ, XW, row0, (ht - 21) * HALF + lc, XSCALE, nullptr);
            else if (ht < 29) store_half<1>(acc, bj, XG, XW, row0, (ht - 25) * HALF + lc, 1.f, nullptr);
            else if (ht < 53) store_half<2>(acc, bj, G, 3 * DM, row0, (ht - 29) * HALF + lc, 1.f, bgate);
            else if (wc == 0) {
#pragma unroll
                for (int ai = 0; ai < 2; ++ai)
#pragma unroll
                    for (int m = 0; m < 4; ++m) { const int row = row0 + ai * HALF + m * 16;
                        const f32x4 c = *(const f32x4*)(CS + (unsigned)(row * 32 + 4 * fq)), s = *(const f32x4*)(CS + (unsigned)(row * 32 + 16 + 4 * fq));
                        const f32x4 x1 = acc[ai][bj][m][0], x2 = acc[ai][bj][m][1];
                        const f32x4 o1 = x1 * c - x2 * s, o2 = x1 * s + x2 * c;
                        u32x2 w1, w2; w1.x = cvt_pk_bf16(o1[0], o1[1]); w1.y = cvt_pk_bf16(o1[2], o1[3]); w2.x = cvt_pk_bf16(o2[0], o2[1]); w2.y = cvt_pk_bf16(o2[2], o2[3]);
                        *(u32x2*)(KR + (unsigned)(row * ROPE + 4 * fq)) = w1; *(u32x2*)(KR + (unsigned)(row * ROPE + 16 + 4 * fq)) = w2; asm volatile("" ::: "memory"); }
            }
        }
    }
};
__device__ __forceinline__ float row_rs(const float* psq, int row, int g0, int ng, float inv_n) {
    float s = 0.f;
#pragma unroll
    for (int g = 0; g < 12; ++g) if (g < ng) s += psq[(unsigned)(row * NPSQ + g0 + g)];
    return __builtin_amdgcn_rsqf(s * inv_n + EPS);
}
struct EpiKV {
    bf16_t* KV; const float* PSQ;
    __device__ __forceinline__ bool zero_after(const Unit&) const { return true; }
    __device__ __forceinline__ void operator()(Acc& acc, const Unit& u) const {
        const int tid_ = opaque_tid(), wid_ = __builtin_amdgcn_readfirstlane(tid_ >> 6), wr = wid_ >> 2, wc = wid_ & 3, fr = tid_ & 15, fq = (tid_ & 63) >> 4;
        const int row0 = u.pm * BM + wr * 64 + fr;
#pragma unroll
        for (int ai = 0; ai < 2; ++ai)
#pragma unroll
            for (int m = 0; m < 4; ++m) { const int row = row0 + ai * HALF + m * 16; const float rs = row_rs(PSQ, row, 12, 8, 1.f / KVL);
#pragma unroll
                for (int bj = 0; bj < 2; ++bj) *(u32x4*)(KV + (unsigned)(row * KVW + u.pn * BM + bj * HALF + wc * 32 + fq * 8)) = pack8(acc[ai][bj][m][0] * rs, acc[ai][bj][m][1] * rs);
                asm volatile("" ::: "memory"); }
    }
};
struct EpiQ {
    bf16_t* Q; const float* PSQ; const float* CS;
    __device__ __forceinline__ bool zero_after(const Unit&) const { return true; }
    __device__ __forceinline__ void operator()(Acc& acc, const Unit& u) const {
        const int tid_ = opaque_tid(), wid_ = __builtin_amdgcn_readfirstlane(tid_ >> 6), wr = wid_ >> 2, wc = wid_ & 3, fr = tid_ & 15, fq = (tid_ & 63) >> 4;
        const int row0 = u.pm * BM + wr * 64 + fr;
#pragma unroll
        for (int ai = 0; ai < 2; ++ai)
#pragma unroll
            for (int m = 0; m < 4; ++m) { const int row = row0 + ai * HALF + m * 16; const float rs = row_rs(PSQ, row, 0, 12, 1.f / QL) * QSCALE;
#pragma unroll
                for (int bj = 0; bj < 2; ++bj) { const int g32 = u.pn * 8 + bj * 4 + wc; bf16_t* qp = Q + (unsigned)(row * QW + g32 * 32);
                    if (g32 % 3 != 2) *(u32x4*)(qp + fq * 8) = pack8(acc[ai][bj][m][0] * rs, acc[ai][bj][m][1] * rs);
                    else { const f32x4 c = *(const f32x4*)(CS + (unsigned)(row * 32 + 4 * fq)), s = *(const f32x4*)(CS + (unsigned)(row * 32 + 16 + 4 * fq));
                        const f32x4 x1 = acc[ai][bj][m][0] * rs, x2 = acc[ai][bj][m][1] * rs; const f32x4 o1 = x1 * c - x2 * s, o2 = x1 * s + x2 * c;
                        u32x2 w1, w2; w1.x = cvt_pk_bf16(o1[0], o1[1]); w1.y = cvt_pk_bf16(o1[2], o1[3]); w2.x = cvt_pk_bf16(o2[0], o2[1]); w2.y = cvt_pk_bf16(o2[2], o2[3]);
                        *(u32x2*)(qp + 4 * fq) = w1; *(u32x2*)(qp + 16 + 4 * fq) = w2; } }
                asm volatile("" ::: "memory"); }
    }
};
struct EpiMerge {
    bf16_t* MERGED; const bf16_t* G;
    __device__ __forceinline__ bool zero_after(const Unit& u) const { return u.sub == 2; }
    static __device__ __forceinline__ void unpack8(const u32x4 g, f32x4& a, f32x4& b) {
        a = (f32x4){fmaxf(bf_lo(g.x), 1e-30f), fmaxf(bf_hi(g.x), 1e-30f), fmaxf(bf_lo(g.y), 1e-30f), fmaxf(bf_hi(g.y), 1e-30f)};
        b = (f32x4){fmaxf(bf_lo(g.z), 1e-30f), fmaxf(bf_hi(g.z), 1e-30f), fmaxf(bf_lo(g.w), 1e-30f), fmaxf(bf_hi(g.w), 1e-30f)}; }
    __device__ __forceinline__ void operator()(Acc& acc, const Unit& u) const {
        const int tid_ = opaque_tid(), wid_ = __builtin_amdgcn_readfirstlane(tid_ >> 6), wr = wid_ >> 2, wc = wid_ & 3, fr = tid_ & 15, fq = (tid_ & 63) >> 4;
        const int row0 = u.pm * BM + wr * 64 + fr;
#pragma unroll
        for (int ai = 0; ai < 2; ++ai)
#pragma unroll
            for (int m = 0; m < 4; ++m) { const int row = row0 + ai * HALF + m * 16;
#pragma unroll
                for (int bj = 0; bj < 2; ++bj) { const int col = u.pn * BM + bj * HALF + wc * 32 + fq * 8;
                    const bf16_t* gp = G + (unsigned)(row * (3 * DM) + u.sub * DM + col);
                    f32x4 fa, fb; unpack8(*(const u32x4*)gp, fa, fb);
                    if (u.sub < 2) { f32x4 da, db; unpack8(*(const u32x4*)(gp + DM), da, db);
#pragma unroll
                        for (int j = 0; j < 4; ++j) { fa[j] *= __builtin_amdgcn_rcpf(da[j]); fb[j] *= __builtin_amdgcn_rcpf(db[j]); }
                        acc[ai][bj][m][0] *= fa; acc[ai][bj][m][1] *= fb; }
                    else *(u32x4*)(MERGED + (unsigned)(row * DM + col)) = pack8(acc[ai][bj][m][0] * fa, acc[ai][bj][m][1] * fb); }
                asm volatile("" ::: "memory"); }
    }
};
struct EpiOut {
    const float* X; float* OUT;
    __device__ __forceinline__ bool zero_after(const Unit&) const { return true; }
    __device__ __forceinline__ void operator()(Acc& acc, const Unit& u) const {
        const int tid_ = opaque_tid(), wid_ = __builtin_amdgcn_readfirstlane(tid_ >> 6), wr = wid_ >> 2, wc = wid_ & 3, fr = tid_ & 15, fq = (tid_ & 63) >> 4;
        const int row0 = u.pm * BM + wr * 64 + fr;
#pragma unroll
        for (int ai = 0; ai < 2; ++ai)
#pragma unroll
            for (int m = 0; m < 4; ++m) { const int row = row0 + ai * HALF + m * 16;
#pragma unroll
                for (int bj = 0; bj < 2; ++bj) { const unsigned off = (unsigned)(row * DM + u.pn * BM + bj * HALF + wc * 32 + fq * 8);
                    const f32x4 x0 = *(const f32x4*)(X + off), x1 = *(const f32x4*)(X + off + 4);
                    *(f32x4*)(OUT + off) = x0 + acc[ai][bj][m][0]; *(f32x4*)(OUT + off + 4) = x1 + acc[ai][bj][m][1]; }
                asm volatile("" ::: "memory"); }
    }
};
}

namespace att {
constexpr int NW = 8, QBLK = 32, KVBLK = 64, QB = NW * QBLK;
constexpr int SHM_K = KVBLK * 256, SHM_V = KVBLK * 64 * 2;
constexpr int OFF_V = 0, OFF_K = 2 * SHM_V, OFF_WS = OFF_K + 2 * SHM_K, OFF_OST = OFF_WS + NW * 64 * 4, LDS_BYTES = OFF_OST + NW * 8192;
constexpr float THR = 4.f;
#define KSWZ(row, colB) ((row) * 256 + ((colB) ^ (((row) & 7) << 4)))
#define SBAR() __builtin_amdgcn_sched_barrier(0)
__device__ __forceinline__ int v_st(int k, int c) { const int kk = (k & ~0xC) | ((k & 4) << 1) | ((k & 8) >> 1); return ((kk >> 3) * 2 + (c >> 5)) * 512 + ((kk & 7) * 32 + (c & 31)) * 2; }
__device__ __forceinline__ int v_rd_base(int lane) { return ((lane & 3) << 3) | (((lane >> 2) & 3) << 6) | (((lane >> 4) & 1) << 5) | (((lane >> 5) & 1) << 8); }
constexpr int v_rd_off(int d0, int ks, int half) { return d0 * 512 + ks * 2048 + half * 1024; }
__device__ __forceinline__ int crow(int r, int hi) { return (r & 3) + 8 * (r >> 2) + 4 * hi; }
__device__ __forceinline__ void mask_tile(f32x16& p0, f32x16& p1, int dq) {
    const float NEG = -__builtin_inff();
#pragma unroll
    for (int r = 0; r < 16; ++r) { const int c = (r & 3) + 8 * (r >> 2); if (dq - c < 0) p0[r] = NEG; if (dq - c - 32 < 0) p1[r] = NEG; }
}
__device__ __forceinline__ void partialSM(f32x16& p0, f32x16& p1, float& m_reg, float& alpha) {
    float pmax = p0[0];
#pragma unroll
    for (int r = 1; r < 16; ++r) pmax = fmaxf(pmax, p0[r]);
#pragma unroll
    for (int r = 0; r < 16; ++r) pmax = fmaxf(pmax, p1[r]);
    { auto rr = __builtin_amdgcn_permlane32_swap(__float_as_uint(pmax), __float_as_uint(pmax), false, false); pmax = fmaxf(__uint_as_float(rr[0]), __uint_as_float(rr[1])); }
    float mn;
    if (__builtin_expect(__all(pmax - m_reg <= THR), 1)) { mn = m_reg; alpha = 1.f; }
    else { mn = fmaxf(m_reg, pmax); alpha = __builtin_amdgcn_exp2f(m_reg - mn); m_reg = mn; }
#pragma unroll
    for (int r = 0; r < 16; ++r) { p0[r] -= mn; p1[r] -= mn; }
#pragma unroll
    for (int r = 0; r < 16; ++r) p0[r] = __builtin_amdgcn_exp2f(p0[r]);
}
__device__ __forceinline__ void finishSM(f32x16& p0, f32x16& p1, float alpha, float& l_reg, bf16x8& pa0, bf16x8& pa1, bf16x8& pa2, bf16x8& pa3) {
#pragma unroll
    for (int r = 0; r < 16; ++r) p1[r] = __builtin_amdgcn_exp2f(p1[r]);
    float ps = 0.f;
#pragma unroll
    for (int r = 0; r < 16; ++r) ps += p0[r];
#pragma unroll
    for (int r = 0; r < 16; ++r) ps += p1[r];
    { auto rr = __builtin_amdgcn_permlane32_swap(__float_as_uint(ps), __float_as_uint(ps), false, false); ps = __uint_as_float(rr[0]) + __uint_as_float(rr[1]); }
    l_reg = l_reg * alpha + ps;
#define PK4(P, B_, OUT) do { unsigned a0 = cvt_pk_bf16(P[B_+0], P[B_+1]), a1 = cvt_pk_bf16(P[B_+2], P[B_+3]);                          \
        unsigned b0 = cvt_pk_bf16(P[B_+4], P[B_+5]), b1 = cvt_pk_bf16(P[B_+6], P[B_+7]);                                             \
        auto r0 = __builtin_amdgcn_permlane32_swap(a0, b0, false, false); auto r1 = __builtin_amdgcn_permlane32_swap(a1, b1, false, false); \
        u32x4 w = {r0[0], r1[0], r0[1], r1[1]}; OUT = *reinterpret_cast<bf16x8*>(&w); } while (0)
    PK4(p0, 0, pa0); PK4(p0, 8, pa1); PK4(p1, 0, pa2); PK4(p1, 8, pa3);
#undef PK4
}
template <int KB, int ND0>
__device__ __forceinline__ void qkt(f32x16& p0, f32x16& p1, const LAS char* K_lds, int r32, int hi, const bf16x8* qr) {
    p0 = f32x16{}; p1 = f32x16{};
    const LAS char* kb[4];
#pragma unroll
    for (int dd = 0; dd < 4; ++dd) kb[dd] = K_lds + KB * SHM_K + KSWZ(r32, (dd * 16 + hi * 8) * 2);
#pragma unroll
    for (int d0 = 0; d0 < ND0; ++d0) { const LAS char* a = kb[d0 & 3] + (d0 >> 2) * 128;
        const bf16x8 b0 = *(const LAS bf16x8*)(a);
        const bf16x8 b1 = *(const LAS bf16x8*)(a + 32 * 256);
        p0 = __builtin_amdgcn_mfma_f32_32x32x16_bf16(b0, qr[d0], p0, 0, 0, 0);
        p1 = __builtin_amdgcn_mfma_f32_32x32x16_bf16(b1, qr[d0], p1, 0, 0, 0); }
}
template <int VB>
__device__ __forceinline__ void pv_tile(f32x16* o, int vb0, bf16x8 pa0, bf16x8 pa1, bf16x8 pa2, bf16x8 pa3) {
#define TRRD(dst, off) asm volatile("ds_read_b64_tr_b16 %0, %1 offset:%2" : "=&v"(dst) : "v"(vb0), "i"(off) : "memory")
#define PV_D0(d0) do { s16x4 l0, l1, l2, l3, h0, h1, h2, h3; constexpr int b_ = VB * SHM_V + v_rd_off(d0, 0, 0);   \
        TRRD(l0, b_); TRRD(h0, b_ + 1024); TRRD(l1, b_ + 2048); TRRD(h1, b_ + 3072); TRRD(l2, b_ + 4096); TRRD(h2, b_ + 5120); TRRD(l3, b_ + 6144); TRRD(h3, b_ + 7168); \
        asm volatile("s_waitcnt lgkmcnt(0)" ::: "memory"); SBAR();   \
        o[d0] = __builtin_amdgcn_mfma_f32_32x32x16_bf16(pa0, (bf16x8){l0[0], l0[1], l0[2], l0[3], h0[0], h0[1], h0[2], h0[3]}, o[d0], 0, 0, 0);   \
        o[d0] = __builtin_amdgcn_mfma_f32_32x32x16_bf16(pa1, (bf16x8){l1[0], l1[1], l1[2], l1[3], h1[0], h1[1], h1[2], h1[3]}, o[d0], 0, 0, 0);   \
        o[d0] = __builtin_amdgcn_mfma_f32_32x32x16_bf16(pa2, (bf16x8){l2[0], l2[1], l2[2], l2[3], h2[0], h2[1], h2[2], h2[3]}, o[d0], 0, 0, 0);   \
        o[d0] = __builtin_amdgcn_mfma_f32_32x32x16_bf16(pa3, (bf16x8){l3[0], l3[1], l3[2], l3[3], h3[0], h3[1], h3[2], h3[3]}, o[d0], 0, 0, 0); } while (0)
    PV_D0(0); PV_D0(1);
#undef PV_D0
#undef TRRD
}
struct Desc { const bf16_t* Q; const bf16_t* KA; const bf16_t* KB; const bf16_t* V; bf16_t* O; int qpitch, pitchA, pitchB, pitchV, opitch, NT, P0; };
template <int DQK, bool CAUSAL>
__device__ __forceinline__ void unit(const Desc& u, LAS char* lds) {
    constexpr int ND0 = DQK / 16, NCB = DQK / 8 - 8;
    const int tid = opaque_tid(), wid = __builtin_amdgcn_readfirstlane(tid >> 6), lane = tid & 63, r32 = lane & 31, hi = lane >> 5;
    LAS char* V_lds = lds + OFF_V; LAS char* K_lds = lds + OFF_K;
    LAS float* ws = (LAS float*)(lds + OFF_WS) + wid * 64; LAS float* li_l = ws; LAS float* al_l = ws + 32;
    const int sra = tid >> 3, sca = tid & 7;
    const int srb = NCB == 4 ? (tid >> 2) : (tid >> 3), scb = NCB == 4 ? (tid & 3) : (tid & 7);
    const bool hasB = NCB == 8 || wid < 4;
    const int kwa = KSWZ(sra, sca * 16), kwb = KSWZ(srb, (8 + scb) * 16), vw = v_st(sra, sca * 8);
    const bf16_t* pA = u.KA + (size_t)sra * u.pitchA + sca * 8; const bf16_t* pB = u.KB + (size_t)srb * u.pitchB + scb * 8; const bf16_t* pV = u.V + (size_t)sra * u.pitchV + sca * 8;
    bf16x8 st_ka, st_kb = bf16x8{}, st_v;
#define SLOAD(t) do { const size_t k0_ = (size_t)(t) * KVBLK; st_ka = *(const bf16x8*)(pA + k0_ * u.pitchA); if (hasB) st_kb = *(const bf16x8*)(pB + k0_ * u.pitchB); st_v = *(const bf16x8*)(pV + k0_ * u.pitchV); } while (0)
#define SWRITE(bf) do { *(LAS bf16x8*)(K_lds + (bf) * SHM_K + kwa) = st_ka; if (hasB) *(LAS bf16x8*)(K_lds + (bf) * SHM_K + kwb) = st_kb; *(LAS bf16x8*)(V_lds + (bf) * SHM_V + vw) = st_v; } while (0)
    const int NT = u.NT;
    const int qlo = u.P0 + wid * QBLK, qm = qlo + r32 - 4 * hi;
    const int vb0 = (int)(unsigned)(uintptr_t)V_lds + v_rd_base(lane);
    float m_reg = -1e30f, l_reg = 0.f; f32x16 o[2]; o[0] = f32x16{}; o[1] = f32x16{};
#define MASKT(P0_, P1_, t) do { if (CAUSAL) { const int kb_ = (t) * KVBLK; if (kb_ + KVBLK - 1 > qlo) mask_tile(P0_, P1_, qm - kb_); } } while (0)
#define RESC(a) do { if (__any((a) < 1.f)) { if (hi == 0) al_l[r32] = (a); LDS_WAIT();              \
                     _Pragma("unroll") for (int d_ = 0; d_ < 2; ++d_) _Pragma("unroll") for (int r = 0; r < 16; ++r) o[d_][r] *= al_l[crow(r, hi)]; } } while (0)
    SLOAD(0);
    bf16x8 qr[ND0];
#pragma unroll
    for (int d0 = 0; d0 < ND0; ++d0) qr[d0] = *(const bf16x8*)(u.Q + (size_t)(wid * QBLK + r32) * u.qpitch + d0 * 16 + hi * 8);
    VM_WAIT(); SWRITE(0); SBAR();
    if (NT > 1) SLOAD(1);
    __syncthreads();
    f32x16 pA0, pA1, pB0, pB1; float alA = 1.f, alB = 1.f; bf16x8 pa0, pa1, pa2, pa3;
    SBAR(); qkt<0, ND0>(pA0, pA1, K_lds, r32, hi, qr);
    MASKT(pA0, pA1, 0); partialSM(pA0, pA1, m_reg, alA);
    if (NT > 1) { VM_WAIT(); SWRITE(1); }
    __syncthreads();
#define HALF_STEP(PX0, PX1, alX, PY0, PY1, alY, t, KB, VB, SB) do {                                                      \
        SBAR(); qkt<KB, ND0>(PX0, PX1, K_lds, r32, hi, qr);                                                             \
        finishSM(PY0, PY1, alY, l_reg, pa0, pa1, pa2, pa3); SBAR();                                                     \
        if ((t) + 1 < NT) { SLOAD((t) + 1); SBAR(); }                                                                   \
        pv_tile<VB>(o, vb0, pa0, pa1, pa2, pa3); MASKT(PX0, PX1, (t)); partialSM(PX0, PX1, m_reg, alX);                 \
        __syncthreads();                                                                                                \
        if ((t) + 1 < NT) { VM_WAIT(); SWRITE(SB); }                                                                    \
        RESC(alX); __syncthreads(); } while (0)
    for (int t = 1; t + 1 < NT; t += 2) {
        HALF_STEP(pB0, pB1, alB, pA0, pA1, alA, t, 1, 0, 0);
        HALF_STEP(pA0, pA1, alA, pB0, pB1, alB, t + 1, 0, 1, 1);
    }
    const bool even = (NT & 1) == 0;
    if (even) { SBAR(); qkt<1, ND0>(pB0, pB1, K_lds, r32, hi, qr); SBAR(); }
    finishSM(pA0, pA1, alA, l_reg, pa0, pa1, pa2, pa3); SBAR();
    pv_tile<0>(o, vb0, pa0, pa1, pa2, pa3);
    if (even) { MASKT(pB0, pB1, NT - 1); partialSM(pB0, pB1, m_reg, alB); RESC(alB);
        finishSM(pB0, pB1, alB, l_reg, pa0, pa1, pa2, pa3); SBAR(); pv_tile<1>(o, vb0, pa0, pa1, pa2, pa3); }
    if (hi == 0) li_l[r32] = l_reg;
    LDS_WAIT();
    LAS float* stg = (LAS float*)(lds + OFF_OST) + wid * 2048;
#pragma unroll
    for (int r = 0; r < 16; ++r) { const int orow = crow(r, hi); const float rl = __builtin_amdgcn_rcpf(li_l[orow]);
#pragma unroll
        for (int d0 = 0; d0 < 2; ++d0) stg[orow * 64 + d0 * 32 + r32] = o[d0][r] * rl; }
    LDS_WAIT();
#pragma unroll
    for (int i = 0; i < 4; ++i) { const int row = i * 8 + (lane >> 3), ch = lane & 7;
        const f32x4 a = *(const LAS f32x4*)(stg + row * 64 + ch * 8), b = *(const LAS f32x4*)(stg + row * 64 + ch * 8 + 4);
        bf16_t* gp = u.O + (size_t)(wid * QBLK + row) * u.opitch + ch * 8; const u32x4 g = *(const u32x4*)gp;
        u32x4 w; w.x = cvt_pk_bf16(a[0] * bf_lo(g.x), a[1] * bf_hi(g.x)); w.y = cvt_pk_bf16(a[2] * bf_lo(g.y), a[3] * bf_hi(g.y));
        w.z = cvt_pk_bf16(b[0] * bf_lo(g.z), b[1] * bf_hi(g.z)); w.w = cvt_pk_bf16(b[2] * bf_lo(g.w), b[3] * bf_hi(g.w));
        *(u32x4*)gp = w; }
    LDS_WAIT();
    __syncthreads();
#undef SLOAD
#undef SWRITE
#undef MASKT
#undef RESC
#undef HALF_STEP
}
#undef KSWZ
#undef SBAR
}

constexpr int NWAVES = 8;
constexpr int N_PHASES = 7;
constexpr int RING_BYTES = 131072;
constexpr int LDSCTL_OFF = RING_BYTES, MISC_OFF = LDSCTL_OFF + 320;
constexpr int LDS_BYTES = 147456;
static_assert(att::LDS_BYTES <= RING_BYTES, "attention LDS");
#define RLX_AGENT __ATOMIC_RELAXED, __HIP_MEMORY_SCOPE_AGENT
typedef GAS unsigned gu32;

#define XB_TMO      128
#define XB_XCNT(j)  (256  + 64 * (j))
#define XB_XSUB(j)  (1280 + 64 * (j))
#define XB_XGEN(j)  (2304 + 64 * (j))
#define XB_TOP      3328
#define XB_TOPGEN   3392
#define XCD_BAR_WORDS 3456
#define XB_SPIN_CAP (1u << 18)
__device__ __forceinline__ unsigned xb_ld(unsigned* p)              { return __hip_atomic_load(p, __ATOMIC_RELAXED, __HIP_MEMORY_SCOPE_AGENT); }
__device__ __forceinline__ unsigned xb_add(unsigned* p, unsigned v) { return __hip_atomic_fetch_add(p, v, __ATOMIC_RELAXED, __HIP_MEMORY_SCOPE_AGENT); }
__device__ __forceinline__ unsigned xb_xcc_id() { return (unsigned)__builtin_amdgcn_s_getreg((3 << 11) | 20) & 0xFu; }
#define XB_SPIN(cond, bar) do { unsigned _sp = 0; while (cond) { __builtin_amdgcn_s_sleep(1); \
    if ((++_sp & 255u) == 0u) { if (xb_ld(&(bar)[XB_TMO])) break; if (_sp > XB_SPIN_CAP) { atomicAdd(&(bar)[XB_TMO], 1u); break; } } } } while (0)
struct XcdBarrier { unsigned* bar; unsigned x; volatile LAS unsigned* st; };
__device__ __forceinline__ XcdBarrier xcd_barrier_post(unsigned* bar, volatile LAS unsigned* st) {
    XcdBarrier b; b.bar = bar; b.x = xb_xcc_id(); b.st = st;
    if (threadIdx.x == 0) (void)xb_add(&bar[XB_XCNT(b.x)], 1u);
    return b;
}
__device__ __forceinline__ void xcd_barrier_complete(unsigned* bar, unsigned x, unsigned& nloc, unsigned& nx) {
    const unsigned G = gridDim.x * gridDim.y * gridDim.z;
    unsigned sum, cnt, mine, sp = 0u;
    for (;;) {
        sum = 0u; cnt = 0u; mine = 0u;
#pragma unroll
        for (unsigned j = 0; j < 16; ++j) { const unsigned c = xb_ld(&bar[XB_XCNT(j)]); sum += c; cnt += (c > 0u) ? 1u : 0u; mine = (j == x) ? c : mine; }
        if (sum == G) break;
        __builtin_amdgcn_s_sleep(1);
        if ((++sp & 255u) == 0u) { if (xb_ld(&bar[XB_TMO])) break; if (sp > XB_SPIN_CAP) { atomicAdd(&bar[XB_TMO], 1u); break; } }
    }
    nloc = mine > 0u ? mine : 1u; nx = cnt > 0u ? cnt : 1u;
}
__device__ __forceinline__ void xcd_barrier(const XcdBarrier& b) {
    asm volatile("s_waitcnt vmcnt(0)" ::: "memory");
    __syncthreads();
    if (threadIdx.x == 0) {
        unsigned* bar = b.bar;
        __builtin_amdgcn_s_waitcnt(0);
        unsigned nloc = b.st[0], nx = b.st[1];
        if (nloc == 0u) { xcd_barrier_complete(bar, b.x, nloc, nx); b.st[0] = nloc; b.st[1] = nx; }
        const unsigned old = xb_add(&bar[XB_XSUB(b.x)], 1u);
        const unsigned gen = old / nloc;
        if (old + 1u == (gen + 1u) * nloc) {
            __builtin_amdgcn_fence(__ATOMIC_RELEASE, "agent");
            asm volatile("s_waitcnt vmcnt(0)" ::: "memory");
            const unsigned og = xb_add(&bar[XB_TOP], 1u);
            const unsigned tg = og / nx;
            if (og + 1u == (tg + 1u) * nx) xb_add(&bar[XB_TOPGEN], 1u);
            else XB_SPIN(xb_ld(&bar[XB_TOPGEN]) == tg, bar);
            __builtin_amdgcn_fence(__ATOMIC_ACQUIRE, "agent");
            xb_add(&bar[XB_XGEN(b.x)], 1u);
            asm volatile("s_waitcnt vmcnt(0)" ::: "memory");
        } else {
            XB_SPIN(xb_ld(&bar[XB_XGEN(b.x)]) == gen, bar);
            __builtin_amdgcn_fence(__ATOMIC_ACQUIRE, "agent");
            asm volatile("s_waitcnt vmcnt(0)" ::: "memory");
        }
    }
    __syncthreads();
}

struct Frame {
    LAS unsigned char* lds;
    int vcu, G;
    const float *x, *mem; const int* pos; const float *norm_g, *w_in, *b_gate, *conv_w, *conv_b, *ln_g, *ln_b, *w_co, *qn_g, *w_uq, *kvn_g, *w_ukv, *w_mo, *memn_g, *w_mkv, *w_xo, *w_out, *fin_g;
    float* out; unsigned char* ws; unsigned char* ob;
};
#define WSP(T_, off) ((T_*)(F.ws + (off)))
#define OBP(T_, off) ((T_*)(F.ob + (off)))

__device__ __forceinline__ float rope_inv_freq(int k) {
    float v = 1.0f;
    switch (k) { case 1: v = 0.5623413251903491f; break; case 2: v = 0.31622776601683794f; break; case 3: v = 0.1778279410038923f; break; case 4: v = 0.1f; break;
        case 5: v = 0.05623413251903491f; break; case 6: v = 0.03162277660168379f; break; case 7: v = 0.01778279410038923f; break; case 8: v = 0.01f; break;
        case 9: v = 0.005623413251903491f; break; case 10: v = 0.0031622776601683794f; break; case 11: v = 0.001778279410038923f; break; case 12: v = 0.001f; break;
        case 13: v = 0.0005623413251903491f; break; case 14: v = 0.00031622776601683794f; break; case 15: v = 0.0001778279410038923f; break; default: break; }
    return v;
}
__device__ __forceinline__ void sincos_f64(float a, float& c, float& s) {
    const double x = (double)a;
    const double q = __builtin_rint(x * 0.63661977236758134308);
    double r = __builtin_fma(-q, 1.57079632679489655800e+00, x); r = __builtin_fma(-q, 6.12323399573676603587e-17, r);
    const double r2 = r * r;
    double sp = -1.0 / 1307674368000.0; sp = sp * r2 + 1.0 / 6227020800.0; sp = sp * r2 - 1.0 / 39916800.0; sp = sp * r2 + 1.0 / 362880.0; sp = sp * r2 - 1.0 / 5040.0; sp = sp * r2 + 1.0 / 120.0; sp = sp * r2 - 1.0 / 6.0; sp = sp * r2 * r + r;
    double cp = 1.0 / 20922789888000.0; cp = cp * r2 - 1.0 / 87178291200.0; cp = cp * r2 + 1.0 / 479001600.0; cp = cp * r2 - 1.0 / 3628800.0; cp = cp * r2 + 1.0 / 40320.0; cp = cp * r2 - 1.0 / 720.0; cp = cp * r2 + 1.0 / 24.0; cp = cp * r2 - 0.5; cp = cp * r2 + 1.0;
    const int n = (int)q & 3;
    const double cs = (n == 0) ? cp : (n == 1) ? -sp : (n == 2) ? -cp : sp;
    const double sn = (n == 0) ? sp : (n == 1) ? cp : (n == 2) ? -sp : -cp;
    c = (float)cs; s = (float)sn;
}
__device__ __forceinline__ void p0_transpose_item(const float* W, int N, int k0, int n0, bf16_t* WT, int K, int rho0, bool ident, const float* kscale, LAS float* scr, int lane) {
#pragma unroll 8
    for (int i = 0; i < 32; ++i) { const int kk = 2 * i + (lane >> 5); float v = W[(size_t)(k0 + kk) * N + n0 + (lane & 31)]; if (kscale) v *= kscale[k0 + kk]; scr[kk * 33 + (lane & 31)] = v; }
    LDS_WAIT(); asm volatile("" ::: "memory");
    const int c = lane & 7;
#pragma unroll
    for (int j = 0; j < 4; ++j) { const int s = (lane >> 3) + 8 * j, ps = ident ? s : pg8::perm32(s); const LAS float* sp = scr + (8 * c) * 33 + ps;
        u32x4 o; o.x = cvt_pk_bf16(sp[0 * 33], sp[1 * 33]); o.y = cvt_pk_bf16(sp[2 * 33], sp[3 * 33]); o.z = cvt_pk_bf16(sp[4 * 33], sp[5 * 33]); o.w = cvt_pk_bf16(sp[6 * 33], sp[7 * 33]);
        *(u32x4*)(WT + (size_t)(rho0 + s) * K + k0 + 8 * c) = o; }
    LDS_WAIT(); asm volatile("" ::: "memory");
}
__device__ __forceinline__ int win_group_src(int gi, bool& ident) {
    ident = false;
    if (gi < 32) { const int tile = gi >> 3, half = (gi >> 2) & 1, g32 = gi & 3; return (half ? SRC_GLU : SRC_VAL) + 128 * tile + 32 * g32; }
    const int L0 = 32 * gi;
    if (L0 < SL_QD) return SRC_CG + (L0 - SL_CG);
    if (L0 < SL_KVD) return SRC_QD + (L0 - SL_QD);
    if (L0 < SL_MG) return SRC_KVD + (L0 - SL_KVD);
    if (L0 < SL_XQ) return SRC_MG + (L0 - SL_MG);
    if (L0 < SL_XG) return SRC_XQ + (L0 - SL_XQ);
    if (L0 < SL_G) return SRC_XG + (L0 - SL_XG);
    if (L0 < SL_KR) return SRC_G + (L0 - SL_G);
    ident = true; return SRC_KR;
}
__device__ __forceinline__ void rms_row_to_bf16(const float* xrow, const float* g, bf16_t* orow, int lane) {
    const f32x4* xr = (const f32x4*)xrow + lane; const f32x4* gr = (const f32x4*)g + lane;
    f32x4 v[4]; float s = 0.f;
#pragma unroll
    for (int j = 0; j < 4; ++j) { v[j] = xr[64 * j]; s += (v[j].x * v[j].x + v[j].y * v[j].y) + (v[j].z * v[j].z + v[j].w * v[j].w); }
    const float rs = 1.f / sqrtf(wave_sum(s) * (1.f / DM) + EPS);
    u32x2* o8 = (u32x2*)orow + lane;
#pragma unroll
    for (int j = 0; j < 4; ++j) { const f32x4 gg = gr[64 * j]; u32x2 w; w.x = cvt_pk_bf16(v[j].x * rs * gg.x, v[j].y * rs * gg.y); w.y = cvt_pk_bf16(v[j].z * rs * gg.z, v[j].w * rs * gg.w); o8[64 * j] = w; }
}
__device__ __forceinline__ void p0_prologue(Frame& F) {
    const int tid = opaque_tid(), lane = tid & 63, wave = __builtin_amdgcn_readfirstlane(tid >> 6);
    LAS float* scr = (LAS float*)(F.lds + wave * 16384);
    const int gw = F.vcu * NWAVES + wave, NGW = F.G * NWAVES;
    constexpr int I_WIN = (DIN / 32) * (DM / 64);
    constexpr int I_MKV = (2 * XW / 32) * (DM / 64);
    constexpr int I_UQ = (QW / 32) * (QL / 64);
    constexpr int I_UKV = (KVW / 32) * (KVL / 64);
    constexpr int I_O = (DM / 32) * (CW / 64);
    constexpr int I_OUT = (DM / 32) * (DM / 64);
    constexpr int NITEMS = I_WIN + I_MKV + I_UQ + I_UKV + 3 * I_O + I_OUT;
    for (int it = gw; it < NITEMS; it += NGW) {
        int r = it;
        if (r < I_WIN) { const int gi = r / (DM / 64), kb = r % (DM / 64); bool ident; const int n0 = win_group_src(gi, ident);
            p0_transpose_item(F.w_in, DIN, 64 * kb, n0, WSP(bf16_t, WS_WIN), DM, 32 * gi, ident, nullptr, scr, lane); continue; } r -= I_WIN;
        if (r < I_MKV) { const int gi = r / (DM / 64), kb = r % (DM / 64); p0_transpose_item(F.w_mkv, 2 * XW, 64 * kb, 32 * gi, WSP(bf16_t, WS_WMKV), DM, 32 * gi, false, nullptr, scr, lane); continue; } r -= I_MKV;
        if (r < I_UQ) { const int gi = r / (QL / 64), kb = r % (QL / 64); p0_transpose_item(F.w_uq, QW, 64 * kb, 32 * gi, WSP(bf16_t, WS_WUQ), QL, 32 * gi, (gi % 3) == 2, F.qn_g, scr, lane); continue; } r -= I_UQ;
        if (r < I_UKV) { const int gi = r / (KVL / 64), kb = r % (KVL / 64); p0_transpose_item(F.w_ukv, KVW, 64 * kb, 32 * gi, WSP(bf16_t, WS_WUKV), KVL, 32 * gi, false, F.kvn_g, scr, lane); continue; } r -= I_UKV;
        if (r < 3 * I_O) { const int w = r / I_O, q = r % I_O, gi = q / (CW / 64), kb = q % (CW / 64);
            const float* src = (const float*)pg8::Gemm::sel3(w, (const bf16_t*)F.w_co, (const bf16_t*)F.w_mo, (const bf16_t*)F.w_xo); bf16_t* dst = WSP(bf16_t, WS_WCO) + (size_t)w * DM * CW;
            p0_transpose_item(src, DM, 64 * kb, 32 * gi, dst, CW, 32 * gi, false, nullptr, scr, lane); continue; } r -= 3 * I_O;
        { const int gi = r / (DM / 64), kb = r % (DM / 64); p0_transpose_item(F.w_out, DM, 64 * kb, 32 * gi, WSP(bf16_t, WS_WOUT), DM, 32 * gi, false, nullptr, scr, lane); }
    }
    { u32x4* pad = (u32x4*)(WSP(bf16_t, WS_WIN) + (size_t)DIN * DM); const int n16 = (NSLOT - DIN) * DM * 2 / 16;
        for (int i = F.vcu * (NWAVES * 64) + tid; i < n16; i += F.G * NWAVES * 64) pad[i] = (u32x4){0u, 0u, 0u, 0u}; }
    for (int m = gw; m < T; m += NGW) rms_row_to_bf16(F.x + (size_t)m * DM, F.norm_g, WSP(bf16_t, WS_H) + (size_t)m * DM, lane);
    for (int m = gw; m < NB * NMEM; m += NGW) rms_row_to_bf16(F.mem + (size_t)m * DM, F.memn_g, WSP(bf16_t, WS_MEMN) + (size_t)m * DM, lane);
    for (int i = F.vcu * (NWAVES * 64) + tid; i < T * 16; i += F.G * NWAVES * 64) { const int t = i >> 4, k = i & 15;
        const float ang = (float)F.pos[t] * rope_inv_freq(k); float c, s; sincos_f64(ang, c, s);
        OBP(float, WO_CS)[(size_t)t * 32 + k] = c; OBP(float, WO_CS)[(size_t)t * 32 + 16 + k] = s; }
}

constexpr int CONV_TT = 64, CONV_ROWS = CONV_TT + CKER - 1, CONV_UT_BYTES = CONV_ROWS * CW * 2, CONV_CB_OFF = CONV_UT_BYTES;
static_assert(CONV_CB_OFF % 16 == 0 && CONV_CB_OFF + 16 * CW * 4 <= RING_BYTES, "conv LDS");
__device__ __forceinline__ void conv_phase(Frame& F) {
    const int tid = opaque_tid(), lane = tid & 63, wave = __builtin_amdgcn_readfirstlane(tid >> 6);
    const bf16_t* UPRE = WSP(bf16_t, WS_UPRE); bf16_t* CGp = WSP(bf16_t, WS_CG);
    LAS unsigned char* ut = F.lds; LAS float* cb = (LAS float*)(F.lds + CONV_CB_OFF);
    const int cp = tid & 255, th = tid >> 8, c0 = 2 * cp;
    for (int tile = F.vcu; tile < T / CONV_TT; tile += F.G) {
        const int t0 = tile * CONV_TT, s0 = t0 % SEQ;
        for (int idx = tid; idx < CONV_ROWS * 64; idx += NWAVES * 64) { const int r = idx >> 6, ch = idx & 63;
            u32x4 v = (u32x4){0u, 0u, 0u, 0u}; if (s0 + r - (CKER - 1) >= 0) v = *(const u32x4*)(UPRE + (size_t)(t0 - (CKER - 1) + r) * CW + ch * 8);
            *(LAS u32x4*)(ut + r * (CW * 2) + ch * 16) = v; }
        f32x2 w[CKER];
#pragma unroll
        for (int k = 0; k < CKER; ++k) w[k] = *(const f32x2*)(F.conv_w + k * CW + c0);
        const f32x2 bias = *(const f32x2*)(F.conv_b + c0);
        f32x4 lg[2], lb[2];
#pragma unroll
        for (int j = 0; j < 2; ++j) { lg[j] = *(const f32x4*)(F.ln_g + lane * 8 + 4 * j); lb[j] = *(const f32x4*)(F.ln_b + lane * 8 + 4 * j); }
        __syncthreads();
        for (int pass = 0; pass < 4; ++pass) {
            const int tt0 = pass * 16 + th * 8;
            f32x2 acc[8];
#pragma unroll
            for (int i = 0; i < 8; ++i) acc[i] = bias;
#pragma unroll
            for (int j = 0; j < 8 + CKER - 1; ++j) { const unsigned uu = *(const LAS unsigned*)(ut + (tt0 + j) * (CW * 2) + c0 * 2); const f32x2 uv = (f32x2){bf_lo(uu), bf_hi(uu)};
#pragma unroll
                for (int i = 0; i < 8; ++i) { const int k = j - i; if (k >= 0 && k < CKER) acc[i] += uv * w[k]; } }
#pragma unroll
            for (int i = 0; i < 8; ++i) *(LAS f32x2*)(cb + (th * 8 + i) * CW + c0) = acc[i];
            __syncthreads();
#pragma unroll
            for (int q = 0; q < 2; ++q) { const int lt = wave * 2 + q, tok = t0 + pass * 16 + lt;
                const f32x4 a = *(const LAS f32x4*)(cb + lt * CW + lane * 8), b = *(const LAS f32x4*)(cb + lt * CW + lane * 8 + 4);
                const float mu = wave_sum((a.x + a.y) + (a.z + a.w) + (b.x + b.y) + (b.z + b.w)) * (1.f / CW);
                const f32x4 da = a - mu, db = b - mu;
                const float var = wave_sum((da.x * da.x + da.y * da.y) + (da.z * da.z + da.w * da.w) + (db.x * db.x + db.y * db.y) + (db.z * db.z + db.w * db.w)) * (1.f / CW);
                const float rstd = 1.f / sqrtf(var + EPS);
                f32x4 ya = da * rstd * lg[0] + lb[0], yb = db * rstd * lg[1] + lb[1];
                bf16_t* gp = CGp + (size_t)tok * CW + lane * 8; const u32x4 g = *(const u32x4*)gp;
                u32x4 o; o.x = cvt_pk_bf16(siluf_(ya.x) * bf_lo(g.x), siluf_(ya.y) * bf_hi(g.x)); o.y = cvt_pk_bf16(siluf_(ya.z) * bf_lo(g.y), siluf_(ya.w) * bf_hi(g.y));
                o.z = cvt_pk_bf16(siluf_(yb.x) * bf_lo(g.z), siluf_(yb.y) * bf_hi(g.z)); o.w = cvt_pk_bf16(siluf_(yb.z) * bf_lo(g.w), siluf_(yb.w) * bf_hi(g.w));
                *(u32x4*)gp = o; }
            __syncthreads();
        }
    }
}

__device__ __forceinline__ void final_norm_phase(Frame& F) {
    const int tid = opaque_tid(), lane = tid & 63, wave = __builtin_amdgcn_readfirstlane(tid >> 6);
    const int gw = F.vcu * NWAVES + wave, NGW = F.G * NWAVES;
    for (int m = gw; m < T; m += NGW) {
        f32x4* xr = (f32x4*)(F.out + (size_t)m * DM) + lane; const f32x4* gr = (const f32x4*)F.fin_g + lane;
        f32x4 v[4]; float s = 0.f;
#pragma unroll
        for (int j = 0; j < 4; ++j) { v[j] = xr[64 * j]; s += (v[j].x * v[j].x + v[j].y * v[j].y) + (v[j].z * v[j].z + v[j].w * v[j].w); }
        const float rs = 1.f / sqrtf(wave_sum(s) * (1.f / DM) + EPS);
#pragma unroll
        for (int j = 0; j < 4; ++j) xr[64 * j] = v[j] * rs * gr[64 * j];
    }
}

struct Args { const void* in[21]; float* out; unsigned char* ws; int ph_lo, ph_hi, li, pad; };
__global__ void __launch_bounds__(NWAVES * 64, 2) mk_fwd(Args args) {
    extern __shared__ __attribute__((aligned(16))) unsigned char lds[];
    Frame F;
    F.lds = (LAS unsigned char*)lds;
    F.G = gridDim.x; { const int bx = blockIdx.x; F.vcu = (F.G % 8 == 0) ? (bx % 8) * (F.G / 8) + bx / 8 : bx; }
    F.x = (const float*)args.in[0]; F.mem = (const float*)args.in[1]; F.pos = (const int*)args.in[2]; F.norm_g = (const float*)args.in[3]; F.w_in = (const float*)args.in[4];
    F.b_gate = (const float*)args.in[5]; F.conv_w = (const float*)args.in[6]; F.conv_b = (const float*)args.in[7]; F.ln_g = (const float*)args.in[8]; F.ln_b = (const float*)args.in[9];
    F.w_co = (const float*)args.in[10]; F.qn_g = (const float*)args.in[11]; F.w_uq = (const float*)args.in[12]; F.kvn_g = (const float*)args.in[13]; F.w_ukv = (const float*)args.in[14];
    F.w_mo = (const float*)args.in[15]; F.memn_g = (const float*)args.in[16]; F.w_mkv = (const float*)args.in[17]; F.w_xo = (const float*)args.in[18]; F.w_out = (const float*)args.in[19];
    F.fin_g = (const float*)args.in[20]; F.out = args.out; F.ws = args.ws; F.ob = (unsigned char*)args.out;
    volatile LAS unsigned* MISC = (volatile LAS unsigned*)(F.lds + MISC_OFF);
    for (int u = threadIdx.x; u < (LDS_BYTES - LDSCTL_OFF) / 4; u += NWAVES * 64) ((LAS unsigned*)(F.lds + LDSCTL_OFF))[u] = 0u;
    __syncthreads();
    XcdBarrier bar; bar.bar = (unsigned*)(F.ws + WS_CTL) + 1024; bar.x = 0; bar.st = nullptr;
    if (MK_N_LAUNCHES == 1) bar = xcd_barrier_post((unsigned*)(F.ws + WS_CTL) + 1024, MISC + 8);
    const int lo = args.ph_lo, hi = args.ph_hi;
#ifndef PH_MASK
#define PH_MASK 0x7f
#endif
#define IN(k) (((PH_MASK >> (k)) & 1) && lo <= (k) && (k) < hi)
#define SEAM(k) do { if (IN(k) && IN((k) + 1)) xcd_barrier(bar); } while (0)

    if (IN(0)) { p0_prologue(F); }
    SEAM(0);
    if (IN(1)) {
        pg8::Gemm g{WSP(bf16_t, WS_H), nullptr, nullptr, WSP(bf16_t, WS_WIN), nullptr, nullptr, DM, DM, DM};
        pg8::OrderG1 S; S.init(F.G, (int)blockIdx.x);
        pg8::EpiG1 E{WSP(bf16_t, WS_UPRE), WSP(bf16_t, WS_CG), WSP(bf16_t, WS_QD), WSP(bf16_t, WS_KVD), WSP(bf16_t, WS_MG), WSP(bf16_t, WS_XQ), WSP(bf16_t, WS_XG), WSP(bf16_t, WS_G),
                     OBP(bf16_t, WO_KR), OBP(bf16_t, WO_MEMKV), WSP(float, WS_PSQ), F.b_gate, OBP(float, WO_CS)};
        pg8::gemm_phase<pg8::EpiG1, pg8::OrderG1, true>(F.lds, g, S, E);
    }
    SEAM(1);
    if (IN(2)) {
#ifndef P2M
#define P2M 15
#endif
        if (P2M & 1) { pg8::Gemm g{WSP(bf16_t, WS_KVD), nullptr, nullptr, WSP(bf16_t, WS_WUKV), nullptr, nullptr, KVL, KVL, KVL};
          pg8::StaticOrder S; S.init(T, KVW, F.G, (int)blockIdx.x);
          pg8::EpiKV E{OBP(bf16_t, WO_KV), WSP(float, WS_PSQ)};
          pg8::gemm_phase<pg8::EpiKV, pg8::StaticOrder, true>(F.lds, g, S, E); }
        if (P2M & 2) { pg8::Gemm g{WSP(bf16_t, WS_QD), nullptr, nullptr, WSP(bf16_t, WS_WUQ), nullptr, nullptr, QL, QL, QL};
          pg8::StaticOrder S; S.init(T, QW, F.G, (int)blockIdx.x);
          pg8::EpiQ E{OBP(bf16_t, WO_Q), WSP(float, WS_PSQ), OBP(float, WO_CS)};
          pg8::gemm_phase<pg8::EpiQ, pg8::StaticOrder, true>(F.lds, g, S, E); }
        __syncthreads();
        if (P2M & 4) conv_phase(F);
        if (P2M & 8) for (int i = 0; i < 2; ++i) { const int v = F.vcu; if (v >= 256) break;
            const int b = v >> 6, h = (v >> 4) & 3, qb = v & 15, vh = i;
            att::Desc d; const size_t row0 = (size_t)b * SEQ + (size_t)qb * 256;
            d.Q = WSP(bf16_t, WS_XQ) + row0 * XW + h * XHD; d.qpitch = XW;
            d.KA = OBP(bf16_t, WO_MEMKV) + (size_t)b * NMEM * (2 * XW) + h * XHD; d.pitchA = 2 * XW; d.KB = d.KA + 64; d.pitchB = 2 * XW;
            d.V = OBP(bf16_t, WO_MEMKV) + (size_t)b * NMEM * (2 * XW) + XW + h * XHD + vh * 64; d.pitchV = 2 * XW;
            d.O = WSP(bf16_t, WS_XG) + row0 * XW + h * XHD + vh * 64; d.opitch = XW; d.NT = NMEM / 64; d.P0 = 0;
            att::unit<128, false>(d, (LAS char*)F.lds); }
    }
    SEAM(2);
    if (IN(3)) {
        for (int v = F.vcu; v < 256; v += F.G) {
            const int bh = v >> 3, s = v & 7, b = bh >> 3, h = bh & 7;
            for (int pass = 0; pass < 2; ++pass) { const int qb = pass == 0 ? 15 - s : s;
                att::Desc d; const size_t rowb = (size_t)b * SEQ, row0 = rowb + (size_t)qb * 256;
                d.Q = OBP(bf16_t, WO_Q) + row0 * QW + h * (NOPE + ROPE); d.qpitch = QW;
                d.KA = OBP(bf16_t, WO_KV) + rowb * KVW + h * (NOPE + VH); d.pitchA = KVW; d.KB = OBP(bf16_t, WO_KR) + rowb * ROPE; d.pitchB = ROPE;
                d.V = d.KA + NOPE; d.pitchV = KVW;
                d.O = WSP(bf16_t, WS_MG) + row0 * MW + h * VH; d.opitch = MW; d.NT = (qb + 1) * 4; d.P0 = qb * 256;
                att::unit<96, true>(d, (LAS char*)F.lds); } }
    }
    SEAM(3);
    if (IN(4)) {
        pg8::Gemm g{WSP(bf16_t, WS_CG), WSP(bf16_t, WS_MG), WSP(bf16_t, WS_XG), WSP(bf16_t, WS_WCO), WSP(bf16_t, WS_WMO), WSP(bf16_t, WS_WXO), CW, CW, CW};
        pg8::OrderSub3 S; S.init(T, DM, F.G, (int)blockIdx.x);
        pg8::EpiMerge E{WSP(bf16_t, WS_MERGED), WSP(bf16_t, WS_G)};
        pg8::gemm_phase<pg8::EpiMerge, pg8::OrderSub3, true>(F.lds, g, S, E);
    }
    SEAM(4);
    if (IN(5)) {
        pg8::Gemm g{WSP(bf16_t, WS_MERGED), nullptr, nullptr, WSP(bf16_t, WS_WOUT), nullptr, nullptr, DM, DM, DM};
        pg8::StaticOrder S; S.init(T, DM, F.G, (int)blockIdx.x);
        pg8::EpiOut E{F.x, F.out};
        pg8::gemm_phase<pg8::EpiOut, pg8::StaticOrder, true>(F.lds, g, S, E);
    }
    SEAM(5);
    if (IN(6)) final_norm_phase(F);
#undef IN
#undef SEAM
}

extern "C" void kernel_launch(void* const* d_in, const int* in_sizes, int n_in, void* d_out, int out_size, void* d_ws, size_t ws_size, hipStream_t stream) {
    static int grid = 0;
    if (grid == 0) {
        if (n_in != 21 || in_sizes[0] != T * DM || out_size != T * DM || ws_size < WS_END) { fprintf(stderr, "kernel_launch: unexpected shapes (n_in %d, in0 %d, out %d, ws %zu)\n", n_in, n_in > 0 ? in_sizes[0] : -1, out_size, ws_size); grid = -1; return; }
        int dev = 0, cus = 0, per_cu = 0;
        if (hipGetDevice(&dev) != hipSuccess || hipDeviceGetAttribute(&cus, hipDeviceAttributeMultiprocessorCount, dev) != hipSuccess) { grid = -1; return; }
        if (hipFuncSetAttribute((const void*)mk_fwd, hipFuncAttributeMaxDynamicSharedMemorySize, LDS_BYTES) != hipSuccess) { fprintf(stderr, "kernel_launch: hipFuncSetAttribute failed\n"); grid = -1; return; }
        if (hipOccupancyMaxActiveBlocksPerMultiprocessor(&per_cu, (const void*)mk_fwd, NWAVES * 64, LDS_BYTES) != hipSuccess || per_cu < 1) { fprintf(stderr, "kernel_launch: occupancy query says %d blocks per CU\n", per_cu); (void)hipGetLastError(); grid = -1; return; }
        grid = cus;
        if (grid != 256) fprintf(stderr, "kernel_launch: %d CUs (built for 256)\n", grid);
    }
    if (grid < 0) return;
    (void)hipMemsetAsync((char*)d_ws + WS_CTL, 0, CTL_BYTES, stream);
    Args a{};
    for (int i = 0; i < 21; ++i) a.in[i] = d_in[i];
    a.out = (float*)d_out; a.ws = (unsigned char*)d_ws;
    for (int li = 0; li < MK_N_LAUNCHES; ++li) {
        if (MK_N_LAUNCHES == 1) { a.ph_lo = 0; a.ph_hi = N_PHASES; } else { a.ph_lo = li; a.ph_hi = li + 1; }
        a.li = li;
        hipLaunchKernelGGL(mk_fwd, dim3(grid), dim3(NWAVES * 64), LDS_BYTES, stream, a);
    }
}
```
